# Optimizing an MI355X kernel written in HIP

```python
import math
import jax
import jax.numpy as jnp
from jax import lax
import numpy as np

D_MODEL = 2048
BATCH = 1
SEQ = 8192
DEPTH = 1

PLE_DIM = 256
Q_BLOCK = 128
ROPE_THETA = 10000.0
NORM_EPS = 1e-6

DIFF_HEADS = 8
DIFF_QK_DIM = 64
DIFF_V_DIM = 128
DIFF_WIDTH = DIFF_HEADS * DIFF_V_DIM
DIFF_QK_COLS = DIFF_HEADS * 2 * DIFF_QK_DIM

FOX_HEADS = 8
FOX_HEAD_DIM = 128
FOX_WIDTH = FOX_HEADS * FOX_HEAD_DIM

MIX_WIDTH = DIFF_WIDTH + FOX_WIDTH
IN_PROJ_COLS = 3 * DIFF_QK_COLS // 1 * 0 + 2 * DIFF_QK_COLS + DIFF_WIDTH + 3 * FOX_WIDTH + FOX_HEADS

N_EXPERTS = 64
TOP_K = 8
EXPERT_DIM = 512
SHARED_DIM = 512
ROUTED_SCALE = 2.5

kernel_name = "hybrid_diff_fox_moe_ple_layer"


def _rmsnorm(x, g):
    xf = x.astype(jnp.float32)
    y = xf * lax.rsqrt(jnp.mean(xf * xf, axis=-1, keepdims=True) + NORM_EPS)
    return (y * g.astype(jnp.float32)).astype(x.dtype)


def _rope_tables(seq, dim):
    pos = jnp.arange(seq, dtype=jnp.float32)
    inv_freq = ROPE_THETA ** (-jnp.arange(0, dim, 2, dtype=jnp.float32) / dim)
    ang = pos[:, None] * inv_freq[None, :]
    ang = jnp.concatenate([ang, ang], axis=-1)
    return jnp.cos(ang), jnp.sin(ang)


def _rope(x, cos, sin):
    xf = x.astype(jnp.float32)
    half = xf.shape[-1] // 2
    rot = jnp.concatenate([-xf[..., half:], xf[..., :half]], axis=-1)
    shape = (1, x.shape[1]) + (1,) * (x.ndim - 3) + (x.shape[-1],)
    return (xf * cos.reshape(shape) + rot * sin.reshape(shape)).astype(x.dtype)


def _diff_attention(q, k, v, lam, subln_g, lam_init):
    b, s = q.shape[:2]
    n_blocks = s // Q_BLOCK
    kpos = jnp.arange(s)
    scale = DIFF_QK_DIM ** -0.5

    def block(i):
        start = i * Q_BLOCK
        qb = lax.dynamic_slice_in_dim(q, start, Q_BLOCK, axis=1)
        sc = jnp.einsum('bqhcd,bkhcd->bhcqk', qb, k,
                        preferred_element_type=jnp.float32) * scale
        qpos = start + jnp.arange(Q_BLOCK)
        causal = kpos[None, :] <= qpos[:, None]
        a = jax.nn.softmax(jnp.where(causal, sc, -jnp.inf), axis=-1)
        a = a[:, :, 0] - lam * a[:, :, 1]
        return jnp.einsum('bhqk,bkhd->bqhd', a.astype(v.dtype), v)

    o = lax.map(block, jnp.arange(n_blocks))
    o = jnp.moveaxis(o, 0, 1).reshape(b, s, DIFF_HEADS, DIFF_V_DIM)
    o = _rmsnorm(o, subln_g) * (1.0 - lam_init)
    return o.reshape(b, s, DIFF_WIDTH)


def _forgetting_attention(q, k, v, log_f):
    b, s = q.shape[:2]
    n_blocks = s // Q_BLOCK
    kpos = jnp.arange(s)
    scale = FOX_HEAD_DIM ** -0.5
    c = jnp.moveaxis(jnp.cumsum(log_f, axis=1), 2, 1)

    def block(i):
        start = i * Q_BLOCK
        qb = lax.dynamic_slice_in_dim(q, start, Q_BLOCK, axis=1)
        cq = lax.dynamic_slice_in_dim(c, start, Q_BLOCK, axis=2)
        sc = jnp.einsum('bqhd,bkhd->bhqk', qb, k,
                        preferred_element_type=jnp.float32) * scale
        sc = sc + (cq[..., :, None] - c[..., None, :])
        qpos = start + jnp.arange(Q_BLOCK)
        causal = kpos[None, :] <= qpos[:, None]
        a = jax.nn.softmax(jnp.where(causal, sc, -jnp.inf), axis=-1)
        return jnp.einsum('bhqk,bkhd->bqhd', a.astype(v.dtype), v)

    o = lax.map(block, jnp.arange(n_blocks))
    return jnp.moveaxis(o, 0, 1).reshape(b, s, FOX_WIDTH)


def _swiglu(t, wg, wu, wd):
    return (jax.nn.silu(t @ wg) * (t @ wu)) @ wd


def _moe(x, w_router, router_bias, w_gate, w_up, w_down, ws_gate, ws_up, ws_down):
    b, s, d = x.shape
    t = x.reshape(b * s, d)
    scores = jax.nn.sigmoid(jnp.einsum('td,de->te', t, w_router,
                                       preferred_element_type=jnp.float32))
    _, idx = lax.top_k(scores + router_bias.astype(jnp.float32), TOP_K)
    g = jnp.take_along_axis(scores, idx, axis=-1)
    g = g / jnp.sum(g, axis=-1, keepdims=True) * ROUTED_SCALE
    comb = jnp.einsum('tk,tke->te', g,
                      jax.nn.one_hot(idx, N_EXPERTS, dtype=jnp.float32))

    def expert_step(acc, xs):
        wg, wu, wd, c = xs
        return acc + _swiglu(t, wg, wu, wd) * c[:, None].astype(acc.dtype), None

    y, _ = lax.scan(expert_step, jnp.zeros_like(t), (w_gate, w_up, w_down, comb.T))
    y = y + _swiglu(t, ws_gate, ws_up, ws_down)
    return y.reshape(b, s, d)


def setup_inputs(seed: int = 0) -> dict:
    key = jax.random.key(seed)
    ks = jax.random.split(key, 32)
    f32 = jnp.float32
    n = lambda k, shape, scale: jax.random.normal(k, shape, f32) * scale
    gain = lambda k, shape: 1.0 + 0.05 * jax.random.normal(k, shape, f32)
    L, D, E, F = DEPTH, D_MODEL, N_EXPERTS, EXPERT_DIM
    return {
        "x": jax.random.normal(ks[0], (BATCH, SEQ, D), f32),
        "p": jax.random.normal(ks[1], (DEPTH, BATCH, SEQ, PLE_DIM), f32),
        "attn_norm": gain(ks[2], (L, D)),
        "w_in": n(ks[3], (L, D, IN_PROJ_COLS), D ** -0.5),
        "b_forget": jax.random.uniform(ks[4], (L, FOX_HEADS), f32, 0.0, 5.0),
        "lambda_q1": n(ks[5], (L, DIFF_QK_DIM), 0.1),
        "lambda_k1": n(ks[6], (L, DIFF_QK_DIM), 0.1),
        "lambda_q2": n(ks[7], (L, DIFF_QK_DIM), 0.1),
        "lambda_k2": n(ks[8], (L, DIFF_QK_DIM), 0.1),
        "subln": gain(ks[9], (L, DIFF_V_DIM)),
        "w_o": n(ks[10], (L, MIX_WIDTH, D), MIX_WIDTH ** -0.5),
        "ffn_norm": gain(ks[11], (L, D)),
        "w_router": n(ks[12], (L, D, E), D ** -0.5),
        "router_bias": n(ks[13], (L, E), 0.01),
        "w_gate": n(ks[14], (L, E, D, F), D ** -0.5),
        "w_up": n(ks[15], (L, E, D, F), D ** -0.5),
        "w_down": n(ks[16], (L, E, F, D), F ** -0.5),
        "ws_gate": n(ks[17], (L, D, SHARED_DIM), D ** -0.5),
        "ws_up": n(ks[18], (L, D, SHARED_DIM), D ** -0.5),
        "ws_down": n(ks[19], (L, SHARED_DIM, D), SHARED_DIM ** -0.5),
        "w_ple_gate": n(ks[20], (L, D, D), D ** -0.5),
        "b_ple_gate": n(ks[21], (L, D), 0.02),
        "w_ple_proj": n(ks[22], (L, PLE_DIM, D), PLE_DIM ** -0.5),
        "ple_norm": gain(ks[23], (L, D)),
        "final_norm": gain(ks[24], (D,)),
    }


def reference(x, p, attn_norm, w_in, b_forget, lambda_q1, lambda_k1, lambda_q2,
              lambda_k2, subln, w_o, ffn_norm, w_router, router_bias, w_gate, w_up,
              w_down, ws_gate, ws_up, ws_down, w_ple_gate, b_ple_gate, w_ple_proj,
              ple_norm, final_norm):
    b, s, _ = x.shape
    cos, sin = _rope_tables(s, DIFF_QK_DIM)
    split_at = [DIFF_QK_COLS, 2 * DIFF_QK_COLS, 2 * DIFF_QK_COLS + DIFF_WIDTH,
                2 * DIFF_QK_COLS + DIFF_WIDTH + FOX_WIDTH,
                2 * DIFF_QK_COLS + DIFF_WIDTH + 2 * FOX_WIDTH,
                2 * DIFF_QK_COLS + DIFF_WIDTH + 3 * FOX_WIDTH]
    h = x
    for i in range(DEPTH):
        xn = _rmsnorm(h, attn_norm[i])
        proj = xn @ w_in[i]
        dq, dk, dv, fq, fk, fv, fg = jnp.split(proj, split_at, axis=-1)

        dq = _rope(dq.reshape(b, s, DIFF_HEADS, 2, DIFF_QK_DIM), cos, sin)
        dk = _rope(dk.reshape(b, s, DIFF_HEADS, 2, DIFF_QK_DIM), cos, sin)
        dv = dv.reshape(b, s, DIFF_HEADS, DIFF_V_DIM)
        lam_init = 0.8 - 0.6 * math.exp(-0.3 * i)
        lam = (jnp.exp(jnp.sum(lambda_q1[i].astype(jnp.float32) * lambda_k1[i].astype(jnp.float32)))
               - jnp.exp(jnp.sum(lambda_q2[i].astype(jnp.float32) * lambda_k2[i].astype(jnp.float32)))
               + lam_init)
        o_diff = _diff_attention(dq, dk, dv, lam, subln[i], lam_init)

        fq = fq.reshape(b, s, FOX_HEADS, FOX_HEAD_DIM)
        fk = fk.reshape(b, s, FOX_HEADS, FOX_HEAD_DIM)
        fv = fv.reshape(b, s, FOX_HEADS, FOX_HEAD_DIM)
        log_f = jax.nn.log_sigmoid((fg + b_forget[i]).astype(jnp.float32))
        o_fox = _forgetting_attention(fq, fk, fv, log_f)

        h = h + jnp.concatenate([o_diff, o_fox], axis=-1) @ w_o[i]

        h = h + _moe(_rmsnorm(h, ffn_norm[i]), w_router[i], router_bias[i],
                     w_gate[i], w_up[i], w_down[i], ws_gate[i], ws_up[i], ws_down[i])

        gate = jax.nn.sigmoid(h @ w_ple_gate[i] + b_ple_gate[i])
        h = h + gate * _rmsnorm(p[i] @ w_ple_proj[i], ple_norm[i])
    return _rmsnorm(h, final_norm)
```

```cpp
#include <hip/hip_runtime.h>
#include <cstdio>
#include <cstdint>
#include <cmath>

#ifndef MK_N_LAUNCHES
#define MK_N_LAUNCHES 11
#endif

#define GAS __attribute__((address_space(1)))
#define LAS __attribute__((address_space(3)))
typedef unsigned short bf16_t;
typedef short bf16x8 __attribute__((ext_vector_type(8)));
typedef short s16x4 __attribute__((ext_vector_type(4)));
typedef float f32x4 __attribute__((ext_vector_type(4)));
typedef float f32x2 __attribute__((ext_vector_type(2)));
typedef float f32x16 __attribute__((ext_vector_type(16)));
typedef unsigned u32x4 __attribute__((ext_vector_type(4)));
typedef unsigned u32x2 __attribute__((ext_vector_type(2)));
typedef GAS unsigned gu32;

constexpr int T = 8192, DM = 2048, NPROJ = 6144, LDW_IN = 6152, NE = 64, NEX = 65, FE = 512, PLE = 256;
constexpr int NH = 8, HD = 128;
constexpr int NSLOT = T * 8 + T;
constexpr int DUMMY = NSLOT;
constexpr float NORM_EPS = 1e-6f;
constexpr float LOG2E = 1.4426950408889634f;
constexpr int NPH = 11;

constexpr size_t MiB = 1u << 20;
constexpr size_t WS_CTL = 0, CTL_ZERO_BYTES = 1 * MiB;
constexpr size_t WS_WIN = 1 * MiB;
constexpr size_t WS_WO = 25 * MiB;
constexpr size_t WS_WPG = 33 * MiB;
constexpr size_t WS_WPP = 41 * MiB;
constexpr size_t WS_WR = 42 * MiB;
constexpr size_t WS_WG1 = 43 * MiB;
constexpr size_t WS_WD = 303 * MiB;
constexpr size_t WS_XN = 433 * MiB;
constexpr size_t WS_PE = 466 * MiB;
constexpr size_t WS_H1 = 498 * MiB;
constexpr size_t WS_HID = 562 * MiB;
constexpr size_t WS_MISC = 635 * MiB;
constexpr size_t WS_COS = WS_MISC, WS_SIN = WS_MISC + 1 * MiB;
constexpr size_t WS_NB = WS_MISC + 2 * MiB;
constexpr size_t WS_LOGF = WS_NB + 256 * 1024;
constexpr size_t WS_GW = WS_LOGF + 256 * 1024;
constexpr size_t WS_ROWL = WS_GW + 256 * 1024;
constexpr size_t WS_PB = WS_MISC + 6 * MiB;
constexpr size_t WS_BIG = 647 * MiB;
constexpr size_t WS_QKV = WS_BIG;
constexpr size_t WS_OD = WS_BIG + 96 * MiB;
constexpr size_t WS_CAT = WS_BIG + 128 * MiB;
constexpr size_t WS_END = 936 * MiB;
static_assert(WS_ROWL + (size_t)NEX * 8192 * 4 <= WS_PB && WS_PB + (size_t)T * PLE * 2 <= WS_BIG, "misc map");
static_assert(WS_BIG + (size_t)(NSLOT + 1) * DM * 2 <= WS_END && WS_HID + (size_t)(NSLOT + 1) * FE * 2 <= WS_MISC, "ws map");
static_assert(WS_WG1 + (size_t)NEX * 1024 * 2048 * 2 <= WS_WD && WS_WD + (size_t)NEX * 2048 * 512 * 2 <= WS_XN && WS_XN + (size_t)(T + 1) * DM * 2 <= WS_PE, "ws map 2");
constexpr int CW_TMO = 0, CW_CODE = 1;
constexpr int CW_BAR = 4096;
constexpr int CW_QFOX = 32768, CW_QDIFF = 32768 + 64;
constexpr int CW_CNT = 40960;

constexpr int RING_BYTES = 131072;
constexpr int TBL_OFF = 131072;
constexpr int MOE_OFF = TBL_OFF + 4096;
constexpr int LDS_BYTES = 147456;
constexpr int MISC_OFF = LDS_BYTES - 256;
static_assert(MOE_OFF + 1024 <= MISC_OFF, "LDS map");

#define RLX_AGENT __ATOMIC_RELAXED, __HIP_MEMORY_SCOPE_AGENT
#define LDS_WAIT() asm volatile("s_waitcnt lgkmcnt(0)" ::: "memory")
#define VM_WAIT() asm volatile("s_waitcnt vmcnt(0)" ::: "memory")

__device__ __forceinline__ unsigned cvt_pk_bf16(float lo, float hi) { unsigned r; asm volatile("v_cvt_pk_bf16_f32 %0, %1, %2" : "=v"(r) : "v"(lo), "v"(hi)); return r; }
__device__ __forceinline__ float bf2f(unsigned short b) { return __uint_as_float((unsigned)b << 16); }
__device__ __forceinline__ float bflo(unsigned w) { return __uint_as_float(w << 16); }
__device__ __forceinline__ float bfhi(unsigned w) { return __uint_as_float(w & 0xffff0000u); }
__device__ __forceinline__ float wave_sum(float v) {
#pragma unroll
    for (int o = 1; o < 64; o <<= 1) v += __shfl_xor(v, o);
    return v;
}
__device__ __forceinline__ float wave_max(float v) {
#pragma unroll
    for (int o = 1; o < 64; o <<= 1) v = fmaxf(v, __shfl_xor(v, o));
    return v;
}

#define XB_TMO      128
#define XB_XCNT(j)  (256  + 64 * (j))
#define XB_XSUB(j)  (1280 + 64 * (j))
#define XB_XGEN(j)  (2304 + 64 * (j))
#define XB_TOP      3328
#define XB_TOPGEN   3392
#define XCD_BAR_WORDS 3456
#define XB_SPIN_CAP (1u << 18)
__device__ __forceinline__ unsigned xb_ld(unsigned* p)              { return __hip_atomic_load(p, __ATOMIC_RELAXED, __HIP_MEMORY_SCOPE_AGENT); }
__device__ __forceinline__ unsigned xb_add(unsigned* p, unsigned v) { return __hip_atomic_fetch_add(p, v, __ATOMIC_RELAXED, __HIP_MEMORY_SCOPE_AGENT); }
__device__ __forceinline__ unsigned xb_xcc_id() { return (unsigned)__builtin_amdgcn_s_getreg((3 << 11) | 20) & 0xFu; }
#define XB_SPIN(cond, bar) do { unsigned _sp = 0; while (cond) { __builtin_amdgcn_s_sleep(1); \
    if ((++_sp & 255u) == 0u) { if (xb_ld(&(bar)[XB_TMO])) break; if (_sp > XB_SPIN_CAP) { atomicAdd(&(bar)[XB_TMO], 1u); break; } } } } while (0)
struct XcdBarrier { unsigned* bar; unsigned x; volatile LAS unsigned* st; };
__device__ __forceinline__ XcdBarrier xcd_barrier_post(unsigned* bar, volatile LAS unsigned* st) {
    XcdBarrier b; b.bar = bar; b.x = xb_xcc_id(); b.st = st;
    if (threadIdx.x == 0) (void)xb_add(&bar[XB_XCNT(b.x)], 1u);
    return b;
}
__device__ __forceinline__ void xcd_barrier_complete(unsigned* bar, unsigned x, unsigned& nloc, unsigned& nx) {
    const unsigned G = gridDim.x * gridDim.y * gridDim.z;
    unsigned sum, cnt, mine, sp = 0u;
    for (;;) {
        sum = 0u; cnt = 0u; mine = 0u;
#pragma unroll
        for (unsigned j = 0; j < 16; ++j) { const unsigned c = xb_ld(&bar[XB_XCNT(j)]); sum += c; cnt += (c > 0u) ? 1u : 0u; mine = (j == x) ? c : mine; }
        if (sum == G) break;
        __builtin_amdgcn_s_sleep(1);
        if ((++sp & 255u) == 0u) { if (xb_ld(&bar[XB_TMO])) break; if (sp > XB_SPIN_CAP) { atomicAdd(&bar[XB_TMO], 1u); break; } }
    }
    nloc = mine > 0u ? mine : 1u; nx = cnt > 0u ? cnt : 1u;
}
__device__ __forceinline__ void xcd_barrier(const XcdBarrier& b) {
    asm volatile("s_waitcnt vmcnt(0)" ::: "memory");
    __syncthreads();
    if (threadIdx.x == 0) {
        unsigned* bar = b.bar;
        __builtin_amdgcn_s_waitcnt(0);
        unsigned nloc = b.st[0], nx = b.st[1];
        if (nloc == 0u) { xcd_barrier_complete(bar, b.x, nloc, nx); b.st[0] = nloc; b.st[1] = nx; }
        const unsigned old = xb_add(&bar[XB_XSUB(b.x)], 1u);
        const unsigned gen = old / nloc;
        if (old + 1u == (gen + 1u) * nloc) {
            __builtin_amdgcn_fence(__ATOMIC_RELEASE, "agent");
            asm volatile("s_waitcnt vmcnt(0)" ::: "memory");
            const unsigned og = xb_add(&bar[XB_TOP], 1u);
            const unsigned tg = og / nx;
            if (og + 1u == (tg + 1u) * nx) xb_add(&bar[XB_TOPGEN], 1u);
            else XB_SPIN(xb_ld(&bar[XB_TOPGEN]) == tg, bar);
            __builtin_amdgcn_fence(__ATOMIC_ACQUIRE, "agent");
            xb_add(&bar[XB_XGEN(b.x)], 1u);
            asm volatile("s_waitcnt vmcnt(0)" ::: "memory");
        } else {
            XB_SPIN(xb_ld(&bar[XB_XGEN(b.x)]) == gen, bar);
            __builtin_amdgcn_fence(__ATOMIC_ACQUIRE, "agent");
            asm volatile("s_waitcnt vmcnt(0)" ::: "memory");
        }
    }
    __syncthreads();
}

namespace pg8 {
constexpr int BM = 256, BK = 64, HALF = 128, HTB = HALF * BK * 2, NXCD = 8, WGM = 8;
__host__ __device__ __forceinline__ int lds_byte(int r, int c) { const int st = (r >> 4) * 2 + (c >> 5), rr = r & 15, cc = c & 31, ob = rr * 64 + cc * 2; return st * 1024 + (ob ^ (((ob >> 9) & 1) << 5)); }
__host__ __device__ __forceinline__ void stage_rc(int b, int& R, int& C) { const int st = b / 1024, sb = b % 1024, swz = sb ^ (((sb >> 9) & 1) << 5); R = (st >> 1) * 16 + swz / 64; C = (st & 1) * 32 + (swz % 64) / 2; }
__host__ __device__ __forceinline__ int perm32(int rho) { const int n = rho >> 4, i = rho & 15; return 8 * (i >> 2) + 4 * n + (i & 3); }

struct Unit { int pm, pn, e, mt, cnt; };

struct SchedDense {
    const char* A; const char* Bt; int nM, nN, nwg, G, c; size_t tstep;
    __device__ void init(const bf16_t* A_, const bf16_t* Bt_, int M, int N, int K, int G_, int c_) { A = (const char*)A_; Bt = (const char*)Bt_; nM = M / BM; nN = N / BM; nwg = nM * nN; G = G_; c = c_; tstep = (size_t)BM * K * 2; }
    __device__ __forceinline__ bool next(int i, Unit& u) const {
        const long L = (long)i * G + c; if (L >= nwg) return false;
        int wgid = (int)L; { const int q = nwg / NXCD, r = nwg % NXCD, xcd = wgid % NXCD, off = wgid / NXCD; wgid = (xcd < r ? xcd * (q + 1) : r * (q + 1) + (xcd - r) * q) + off; }
        const int nig = WGM * nN, gid = wgid / nig, fm = gid * WGM, gsz = (nM - fm) < WGM ? (nM - fm) : WGM;
        u.pm = fm + ((wgid % nig) % gsz); u.pn = (wgid % nig) / gsz; u.e = 0; u.mt = 0; u.cnt = 256; return true;
    }
    __device__ __forceinline__ const char* a_base(const Unit& u) const { return A + (size_t)u.pm * tstep; }
    __device__ __forceinline__ const char* b_base(const Unit& u) const { return Bt + (size_t)u.pn * tstep; }
    __device__ __forceinline__ const int* tbl_src(const Unit&) const { return nullptr; }
    __device__ __forceinline__ unsigned a_off(unsigned) const { return 0u; }
};
struct SchedMoe {
    const char* A; const char* Bt; size_t estride, tstep; const int* rowlist; const LAS int* cnts; const LAS int* tstart; int nN, total, G, c, K, g1;
    __device__ __forceinline__ bool next(int i, Unit& u) const {
        const int L = i * G + c; if (L >= total) return false;
        const int mtg = L / nN; u.pn = L - mtg * nN;
        int e = 0;
        for (int j = 1; j < NEX; ++j) e += (tstart[j] <= mtg) ? 1 : 0;
        u.e = e; u.mt = mtg - tstart[e]; const int rem = cnts[e] - 256 * u.mt; u.cnt = rem < 256 ? rem : 256; u.pm = 0; return true;
    }
    __device__ __forceinline__ const char* a_base(const Unit&) const { return A; }
    __device__ __forceinline__ const char* b_base(const Unit& u) const { return Bt + (size_t)u.e * estride + (size_t)u.pn * tstep; }
    __device__ __forceinline__ const int* tbl_src(const Unit& u) const { return rowlist + u.e * 8192 + 256 * u.mt; }
    __device__ __forceinline__ unsigned a_off(unsigned slot) const { const unsigned row = g1 ? (slot < 65536u ? (slot >> 3) : slot - 65536u) : slot; return row * (unsigned)(K * 2); }
};

template <class Epi, class Sched, bool ALIGN_EPI, bool GATHER>
__device__ __forceinline__ void gemm_phase(LAS unsigned char* lds, const int K, const Sched& S, const Epi& E) {
    const int tid = threadIdx.x, wid = __builtin_amdgcn_readfirstlane(tid >> 6), lane = tid & 63, wr = wid >> 2, wc = wid & 3, fr = lane & 15, fq = lane >> 4;
    const int nt = K / BK;
    unsigned voffA[2], voffB[2]; int RA[2], CA[2];
#pragma unroll
    for (int i = 0; i < 2; ++i) { int R, C; stage_rc(tid * 16 + i * 8192, R, C); const int Rb = Epi::PERM ? ((R & ~31) + perm32(R & 31)) : R;
        voffA[i] = (unsigned)(R * K + C) * 2u; voffB[i] = (unsigned)(Rb * K + C) * 2u; RA[i] = R; CA[i] = C; }
    const size_t kstep = (size_t)(BK * 2);
    const size_t hstep = (size_t)HALF * K * 2;
    const unsigned ldsw = (unsigned)wid * 1024u;
    const int aoff = lds_byte(wr * 64 + fr, fq * 8), boff = lds_byte(wc * 32 + fr, fq * 8);
    LAS unsigned* tblbase = (LAS unsigned*)(lds + TBL_OFF);
#define PG8_SA(b, h) (((b) * 2 + (h)) * HTB)
#define PG8_SB(b, h) ((4 + (b) * 2 + (h)) * HTB)
#define PG8_STAGEB(bufoff, gbase) do { _Pragma("unroll") for (int _i = 0; _i < 2; ++_i) \
        __builtin_amdgcn_global_load_lds((const unsigned*)((const char*)(gbase) + voffB[_i]), (LAS unsigned*)(lds + (bufoff) + ldsw + _i * 8192), 16, 0, 0); } while (0)
#define PG8_STAGEA(bufoff, gbase, o0, o1) do { \
        __builtin_amdgcn_global_load_lds((const unsigned*)((const char*)(gbase) + (o0)), (LAS unsigned*)(lds + (bufoff) + ldsw), 16, 0, 0); \
        __builtin_amdgcn_global_load_lds((const unsigned*)((const char*)(gbase) + (o1)), (LAS unsigned*)(lds + (bufoff) + ldsw + 8192), 16, 0, 0); } while (0)
#define PG8_LDA(dst, b, h) do { _Pragma("unroll") for (int m = 0; m < 4; ++m) _Pragma("unroll") for (int k = 0; k < 2; ++k) dst[m][k] = *(const LAS bf16x8*)(lds + PG8_SA(b, h) + aoff + m * 2048 + k * 1024); } while (0)
#define PG8_LDB(dst, b, h) do { _Pragma("unroll") for (int n = 0; n < 2; ++n) _Pragma("unroll") for (int k = 0; k < 2; ++k) dst[n][k] = *(const LAS bf16x8*)(lds + PG8_SB(b, h) + boff + n * 2048 + k * 1024); } while (0)
#define PG8_MMA(ai, bj, At, Bt) do { __builtin_amdgcn_s_setprio(1); _Pragma("unroll") for (int m = 0; m < 4; ++m) _Pragma("unroll") for (int n = 0; n < 2; ++n) _Pragma("unroll") for (int k = 0; k < 2; ++k) \
        acc[ai][bj][m][n] = __builtin_amdgcn_mfma_f32_16x16x32_bf16(Bt[n][k], At[m][k], acc[ai][bj][m][n], 0, 0, 0); __builtin_amdgcn_s_setprio(0); } while (0)
#define PG8_WAIT_V(n) asm volatile("s_waitcnt vmcnt(" #n ")" ::: "memory")
#define PG8_WAIT_L(n) asm volatile("s_waitcnt lgkmcnt(" #n ")" ::: "memory")
#define PG8_BAR __builtin_amdgcn_s_barrier()
#define PG8_SCHED __builtin_amdgcn_sched_barrier(0)
#define PG8_GOFF(dst, tb, U) do { _Pragma("unroll") for (int _h = 0; _h < 2; ++_h) _Pragma("unroll") for (int _i = 0; _i < 2; ++_i) { const int _r = _h * HALF + RA[_i]; \
        const unsigned _s = (_r < (U).cnt) ? (tb)[_r] : (unsigned)DUMMY; dst[_h][_i] = S.a_off(_s) + (unsigned)(CA[_i] * 2); } } while (0)
    Unit cur, nxt; int ui = 0;
    if (!S.next(0, cur)) return;
    f32x4 acc[2][2][4][2];
#pragma unroll
    for (int a = 0; a < 2; ++a)
#pragma unroll
        for (int b = 0; b < 2; ++b)
#pragma unroll
            for (int m = 0; m < 4; ++m)
#pragma unroll
                for (int n = 0; n < 2; ++n) acc[a][b][m][n] = (f32x4){0.f, 0.f, 0.f, 0.f};
    bf16x8 At[4][2], B0[2][2], B1[2][2];
    unsigned offc[2][2], offn[2][2];
    if constexpr (GATHER) {
        if (wid >= 4) __builtin_amdgcn_global_load_lds((const unsigned*)(S.tbl_src(cur) + (wid - 4) * 64 + lane), (LAS unsigned*)(tblbase + (wid - 4) * 64), 4, 0, 0);
        PG8_WAIT_V(0); PG8_BAR; asm volatile("" ::: "memory");
        PG8_GOFF(offc, tblbase, cur);
    } else {
#pragma unroll
        for (int h = 0; h < 2; ++h)
#pragma unroll
            for (int i = 0; i < 2; ++i) offc[h][i] = (unsigned)(h * hstep) + voffA[i];
    }
#pragma unroll
    for (int h = 0; h < 2; ++h)
#pragma unroll
        for (int i = 0; i < 2; ++i) offn[h][i] = offc[h][i];
    const char* cA = S.a_base(cur); const char* cB = S.b_base(cur);
    PG8_STAGEB(PG8_SB(0, 0), cB); PG8_STAGEB(PG8_SB(0, 1), cB + hstep); PG8_STAGEA(PG8_SA(0, 0), cA, offc[0][0], offc[0][1]); PG8_STAGEA(PG8_SA(0, 1), cA, offc[1][0], offc[1][1]);
    if (wr == 1) PG8_BAR;
    PG8_WAIT_V(2); PG8_BAR;
    PG8_STAGEB(PG8_SB(1, 0), cB + kstep); PG8_STAGEA(PG8_SA(1, 0), cA + kstep, offc[0][0], offc[0][1]); PG8_STAGEB(PG8_SB(1, 1), cB + hstep + kstep);
    PG8_WAIT_V(6); PG8_BAR;
    for (;;) {
        const bool has_next = S.next(ui + 1, nxt);
        const char* nA = has_next ? S.a_base(nxt) : cA; const char* nB = has_next ? S.b_base(nxt) : cB;
        LAS unsigned* tbn = tblbase + ((ui + 1) & 3) * 256;
        if constexpr (GATHER) { if (has_next && wid >= 4) __builtin_amdgcn_global_load_lds((const unsigned*)(S.tbl_src(nxt) + (wid - 4) * 64 + lane), (LAS unsigned*)(tbn + (wid - 4) * 64), 4, 0, 0); }
        for (int t = 0; t < nt; t += 2) {
            const bool last = (t == nt - 2);
            const char* a1 = cA + (size_t)(t + 1) * kstep;
            const char* a2 = last ? nA : cA + (size_t)(t + 2) * kstep; const char* b2 = last ? nB : cB + (size_t)(t + 2) * kstep;
            const char* a3 = a2 + kstep; const char* b3 = b2 + kstep;
            if constexpr (GATHER) { if (last && has_next) { PG8_GOFF(offn, tbn, nxt); } }
            const unsigned o00 = last ? offn[0][0] : offc[0][0], o01 = last ? offn[0][1] : offc[0][1], o10 = last ? offn[1][0] : offc[1][0], o11 = last ? offn[1][1] : offc[1][1];
            PG8_LDB(B0, 0, 0); PG8_LDB(B1, 0, 1); PG8_SCHED; PG8_LDA(At, 0, 0); PG8_STAGEA(PG8_SA(1, 1), a1, offc[1][0], offc[1][1]);
            PG8_WAIT_V(8); PG8_WAIT_L(0); PG8_BAR; PG8_MMA(0, 0, At, B0); PG8_MMA(0, 1, At, B1); PG8_BAR; PG8_SCHED;
            PG8_LDA(At, 0, 1); PG8_STAGEB(PG8_SB(0, 0), b2); PG8_STAGEB(PG8_SB(0, 1), b2 + hstep); PG8_STAGEA(PG8_SA(0, 0), a2, o00, o01);
            PG8_WAIT_V(8); PG8_WAIT_L(0); PG8_BAR; PG8_MMA(1, 0, At, B0); PG8_MMA(1, 1, At, B1); PG8_BAR; PG8_SCHED;
            PG8_LDB(B0, 1, 0); PG8_LDB(B1, 1, 1); PG8_SCHED; PG8_LDA(At, 1, 0); PG8_STAGEA(PG8_SA(0, 1), a2, o10, o11);
            PG8_WAIT_V(8); PG8_WAIT_L(0); PG8_BAR; PG8_MMA(0, 0, At, B0); PG8_MMA(0, 1, At, B1); PG8_BAR; PG8_SCHED;
            PG8_LDA(At, 1, 1); PG8_STAGEB(PG8_SB(1, 0), b3); PG8_STAGEB(PG8_SB(1, 1), b3 + hstep); PG8_STAGEA(PG8_SA(1, 0), a3, o00, o01);
            PG8_WAIT_V(8); PG8_WAIT_L(0); PG8_BAR; PG8_MMA(1, 0, At, B0); PG8_MMA(1, 1, At, B1); PG8_BAR; PG8_SCHED;
        }
        if constexpr (ALIGN_EPI) { if (wr == 0) PG8_BAR; }
        E(acc, cur, wr, wc, fr, fq, (const LAS unsigned*)(tblbase + (ui & 3) * 256));
        if (!has_next) break;
#pragma unroll
        for (int a = 0; a < 2; ++a)
#pragma unroll
            for (int b = 0; b < 2; ++b)
#pragma unroll
                for (int m = 0; m < 4; ++m)
#pragma unroll
                    for (int n = 0; n < 2; ++n) acc[a][b][m][n] = (f32x4){0.f, 0.f, 0.f, 0.f};
        cur = nxt; cA = nA; cB = nB; ++ui;
#pragma unroll
        for (int h = 0; h < 2; ++h)
#pragma unroll
            for (int i = 0; i < 2; ++i) offc[h][i] = offn[h][i];
        if constexpr (ALIGN_EPI) { if (wr == 1) PG8_BAR; }
    }
    PG8_WAIT_V(0);
    if constexpr (!ALIGN_EPI) { if (wr == 0) PG8_BAR; }
    PG8_BAR;
#undef PG8_SA
#undef PG8_SB
#undef PG8_STAGEA
#undef PG8_STAGEB
#undef PG8_LDA
#undef PG8_LDB
#undef PG8_MMA
#undef PG8_WAIT_V
#undef PG8_WAIT_L
#undef PG8_BAR
#undef PG8_SCHED
#undef PG8_GOFF
}

__device__ __forceinline__ u32x4 pack8(const f32x4& a, const f32x4& b) { u32x4 w; w.x = cvt_pk_bf16(a[0], a[1]); w.y = cvt_pk_bf16(a[2], a[3]); w.z = cvt_pk_bf16(b[0], b[1]); w.w = cvt_pk_bf16(b[2], b[3]); return w; }

struct EpiInProj {
    static constexpr bool PERM = true;
    bf16_t* qkv; const float* cosT; const float* sinT;
    __device__ __forceinline__ void operator()(const f32x4 (&acc)[2][2][4][2], const Unit& u, int wr, int wc, int fr, int fq, const LAS unsigned*) const {
        const int region = u.pn >> 2, pl = u.pn & 3;
        bf16_t* base = qkv + (size_t)region * (NH * T * HD);
        if (region < 2) {
            const int hc = 4 * pl + wc, h = hc >> 1, c = hc & 1;
            bf16_t* hb = base + (size_t)h * T * HD + c * 64 + 8 * fq;
#pragma unroll
            for (int ai = 0; ai < 2; ++ai)
#pragma unroll
                for (int m = 0; m < 4; ++m) {
                    const int row = u.pm * BM + ai * HALF + wr * 64 + m * 16 + fr;
                    const f32x4 c0 = *(const f32x4*)(cosT + (size_t)row * 32 + 8 * fq), c1 = *(const f32x4*)(cosT + (size_t)row * 32 + 8 * fq + 4);
                    const f32x4 s0 = *(const f32x4*)(sinT + (size_t)row * 32 + 8 * fq), s1 = *(const f32x4*)(sinT + (size_t)row * 32 + 8 * fq + 4);
                    const f32x4 x10 = acc[ai][0][m][0], x11 = acc[ai][0][m][1], x20 = acc[ai][1][m][0], x21 = acc[ai][1][m][1];
                    const f32x4 a0 = x10 * c0 - x20 * s0, a1 = x11 * c1 - x21 * s1, b0 = x20 * c0 + x10 * s0, b1 = x21 * c1 + x11 * s1;
                    *(u32x4*)(hb + (size_t)row * HD) = pack8(a0, a1);
                    *(u32x4*)(hb + (size_t)row * HD + 32) = pack8(b0, b1);
                    asm volatile("" ::: "memory");
                }
        } else {
#pragma unroll
            for (int ai = 0; ai < 2; ++ai)
#pragma unroll
                for (int m = 0; m < 4; ++m) {
                    const int row = u.pm * BM + ai * HALF + wr * 64 + m * 16 + fr;
#pragma unroll
                    for (int bj = 0; bj < 2; ++bj) { const int h = 2 * pl + bj;
                        *(u32x4*)(base + ((size_t)h * T + row) * HD + 32 * wc + 8 * fq) = pack8(acc[ai][bj][m][0], acc[ai][bj][m][1]); }
                }
        }
    }
};
struct EpiBf16 {
    static constexpr bool PERM = true;
    bf16_t* O; int ldc;
    __device__ __forceinline__ void operator()(const f32x4 (&acc)[2][2][4][2], const Unit& u, int wr, int wc, int fr, int fq, const LAS unsigned*) const {
#pragma unroll
        for (int ai = 0; ai < 2; ++ai)
#pragma unroll
            for (int m = 0; m < 4; ++m) { bf16_t* rowp = O + (size_t)(u.pm * BM + ai * HALF + wr * 64 + m * 16 + fr) * ldc + u.pn * BM + wc * 32 + 8 * fq;
#pragma unroll
                for (int bj = 0; bj < 2; ++bj) *(u32x4*)(rowp + bj * HALF) = pack8(acc[ai][bj][m][0], acc[ai][bj][m][1]); }
    }
};
struct EpiResF32 {
    static constexpr bool PERM = false;
    const float* base; float* out; int ldc;
    __device__ __forceinline__ void operator()(const f32x4 (&acc)[2][2][4][2], const Unit& u, int wr, int wc, int fr, int fq, const LAS unsigned*) const {
#pragma unroll
        for (int ai = 0; ai < 2; ++ai)
#pragma unroll
            for (int m = 0; m < 4; ++m) { const size_t off = (size_t)(u.pm * BM + ai * HALF + wr * 64 + m * 16 + fr) * ldc + u.pn * BM + wc * 32 + 4 * fq;
#pragma unroll
                for (int bj = 0; bj < 2; ++bj)
#pragma unroll
                    for (int n = 0; n < 2; ++n) { const f32x4 bs = *(const f32x4*)(base + off + bj * HALF + n * 16); *(f32x4*)(out + off + bj * HALF + n * 16) = bs + acc[ai][bj][m][n]; } }
    }
};
struct EpiPle {
    static constexpr bool PERM = false;
    const float* h2; const bf16_t* pe; const float* bias; float* out;
    __device__ __forceinline__ void operator()(const f32x4 (&acc)[2][2][4][2], const Unit& u, int wr, int wc, int fr, int fq, const LAS unsigned*) const {
        const int col0 = u.pn * BM + wc * 32 + 4 * fq;
#pragma unroll
        for (int ai = 0; ai < 2; ++ai)
#pragma unroll
            for (int m = 0; m < 4; ++m) { const size_t off = (size_t)(u.pm * BM + ai * HALF + wr * 64 + m * 16 + fr) * DM + col0;
#pragma unroll
                for (int bj = 0; bj < 2; ++bj)
#pragma unroll
                    for (int n = 0; n < 2; ++n) { const int co = bj * HALF + n * 16;
                        const f32x4 bv = *(const f32x4*)(bias + col0 + co); const f32x4 hv = *(const f32x4*)(h2 + off + co); const u32x2 pw = *(const u32x2*)(pe + off + co);
                        const f32x4 z = acc[ai][bj][m][n] + bv; f32x4 o;
                        const float pv[4] = {bflo(pw.x), bfhi(pw.x), bflo(pw.y), bfhi(pw.y)};
#pragma unroll
                        for (int i = 0; i < 4; ++i) { const float g = __builtin_amdgcn_rcpf(1.f + __builtin_amdgcn_exp2f(-z[i] * LOG2E)); o[i] = hv[i] + g * pv[i]; }
                        *(f32x4*)(out + off + co) = o; } }
    }
};
struct EpiG1 {
    static constexpr bool PERM = true;
    bf16_t* hid;
    __device__ __forceinline__ void operator()(const f32x4 (&acc)[2][2][4][2], const Unit& u, int wr, int wc, int fr, int fq, const LAS unsigned* tbl) const {
#pragma unroll
        for (int ai = 0; ai < 2; ++ai)
#pragma unroll
            for (int m = 0; m < 4; ++m) { const int r = ai * HALF + wr * 64 + m * 16 + fr; const unsigned slot = (r < u.cnt) ? tbl[r] : (unsigned)DUMMY;
                f32x4 o[2];
#pragma unroll
                for (int n = 0; n < 2; ++n)
#pragma unroll
                    for (int i = 0; i < 4; ++i) { const float g = acc[ai][0][m][n][i], up = acc[ai][1][m][n][i]; o[n][i] = g * __builtin_amdgcn_rcpf(1.f + __builtin_amdgcn_exp2f(-g * LOG2E)) * up; }
                *(u32x4*)(hid + (size_t)slot * FE + u.pn * HALF + wc * 32 + 8 * fq) = pack8(o[0], o[1]); }
    }
};
struct EpiG2 {
    static constexpr bool PERM = true;
    bf16_t* out;
    __device__ __forceinline__ void operator()(const f32x4 (&acc)[2][2][4][2], const Unit& u, int wr, int wc, int fr, int fq, const LAS unsigned* tbl) const {
#pragma unroll
        for (int ai = 0; ai < 2; ++ai)
#pragma unroll
            for (int m = 0; m < 4; ++m) { const int r = ai * HALF + wr * 64 + m * 16 + fr; const unsigned slot = (r < u.cnt) ? tbl[r] : (unsigned)DUMMY;
                bf16_t* rowp = out + (size_t)slot * DM + u.pn * BM + wc * 32 + 8 * fq;
#pragma unroll
                for (int bj = 0; bj < 2; ++bj) *(u32x4*)(rowp + bj * HALF) = pack8(acc[ai][bj][m][0], acc[ai][bj][m][1]); }
    }
};
}

namespace att {
constexpr int D = 128, NW = 8, QBLK = 32, KVBLK = 64, QB = NW * QBLK;
constexpr int SHM_V = KVBLK * D * 2, SHM_K = KVBLK * D * 2;
constexpr int LDS_WS = 2 * SHM_V + 2 * SHM_K;
constexpr int LDS_NB = LDS_WS + NW * 64 * 4;
constexpr int LDS_OST = LDS_NB + 512;
constexpr int LDS_BYTES = LDS_OST + NW * 8192;
static_assert(LDS_BYTES <= RING_BYTES + 4096, "attention LDS");
constexpr float THR = 8.f;

#define KSWZ(row, colB) ((row) * 256 + ((colB) ^ (((row) & 7) << 4)))
#define SBAR() __builtin_amdgcn_sched_barrier(0)
__device__ __forceinline__ int v_st(int k, int c) { const int kk = (k & ~0xC) | ((k & 4) << 1) | ((k & 8) >> 1); return ((kk >> 3) * 4 + (c >> 5)) * 512 + ((kk & 7) * 32 + (c & 31)) * 2; }
__device__ __forceinline__ int v_rd_base(int lane) { return ((lane & 3) << 3) | (((lane >> 2) & 3) << 6) | (((lane >> 4) & 1) << 5) | (((lane >> 5) & 1) << 8); }
constexpr int v_rd_off(int d0, int ks, int half) { return d0 * 512 + ks * 4096 + half * 2048; }
__device__ __forceinline__ int crow(int r, int hi) { return (r & 3) + 8 * (r >> 2) + 4 * hi; }
__device__ __forceinline__ bf16x8 load8(const bf16_t* p) { return *reinterpret_cast<const bf16x8*>(p); }

__device__ __forceinline__ void mask_tile(f32x16& p0, f32x16& p1, int dq) {
    const float NEG = -__builtin_inff();
#pragma unroll
    for (int r = 0; r < 16; ++r) {
        const int c = (r & 3) + 8 * (r >> 2);
        if (dq - c < 0) p0[r] = NEG;
        if (dq - c - 32 < 0) p1[r] = NEG;
    }
}
template <bool SCALED>
__device__ __forceinline__ void partialSM(f32x16& p0, f32x16& p1, float& m_reg, float& mn, float& alpha, const float scale) {
    float pmax = p0[0];
#pragma unroll
    for (int r = 1; r < 16; ++r) pmax = fmaxf(pmax, p0[r]);
#pragma unroll
    for (int r = 0; r < 16; ++r) pmax = fmaxf(pmax, p1[r]);
    { auto rr = __builtin_amdgcn_permlane32_swap(__float_as_uint(pmax), __float_as_uint(pmax), false, false);
      pmax = fmaxf(__uint_as_float(rr[0]), __uint_as_float(rr[1])); }
    if constexpr (SCALED) {
        if (__builtin_expect(__all((pmax - m_reg) <= THR * LOG2E), 1)) { mn = m_reg; alpha = 1.f; }
        else { mn = fmaxf(m_reg, pmax); alpha = __builtin_amdgcn_exp2f(m_reg - mn); m_reg = mn; }
#pragma unroll
        for (int r = 0; r < 16; ++r) p0[r] = p0[r] - mn;
#pragma unroll
        for (int r = 0; r < 16; ++r) p1[r] = p1[r] - mn;
    } else {
        const float C2 = LOG2E * scale;
        if (__builtin_expect(__all((pmax - m_reg) * scale <= THR), 1)) { mn = m_reg; alpha = 1.f; }
        else { mn = fmaxf(m_reg, pmax); alpha = __builtin_amdgcn_exp2f((m_reg - mn) * C2); m_reg = mn; }
        const float mnL = -mn * C2;
#pragma unroll
        for (int r = 0; r < 16; ++r) p0[r] = fmaf(p0[r], C2, mnL);
#pragma unroll
        for (int r = 0; r < 16; ++r) p1[r] = fmaf(p1[r], C2, mnL);
    }
#pragma unroll
    for (int r = 0; r < 16; ++r) p0[r] = __builtin_amdgcn_exp2f(p0[r]);
}
__device__ __forceinline__ void finishSM(f32x16& p0, f32x16& p1, float alpha, float& l_reg, bf16x8& pa0, bf16x8& pa1, bf16x8& pa2, bf16x8& pa3) {
#pragma unroll
    for (int r = 0; r < 16; ++r) p1[r] = __builtin_amdgcn_exp2f(p1[r]);
    float ps = 0;
#pragma unroll
    for (int r = 0; r < 16; ++r) ps += p0[r];
#pragma unroll
    for (int r = 0; r < 16; ++r) ps += p1[r];
    { auto rr = __builtin_amdgcn_permlane32_swap(__float_as_uint(ps), __float_as_uint(ps), false, false);
      ps = __uint_as_float(rr[0]) + __uint_as_float(rr[1]); }
    l_reg = l_reg * alpha + ps;
#define PK4(P, B_, OUT) do { unsigned a0 = cvt_pk_bf16(P[B_+0], P[B_+1]), a1 = cvt_pk_bf16(P[B_+2], P[B_+3]);                          \
        unsigned b0 = cvt_pk_bf16(P[B_+4], P[B_+5]), b1 = cvt_pk_bf16(P[B_+6], P[B_+7]);                                             \
        auto r0 = __builtin_amdgcn_permlane32_swap(a0, b0, false, false); auto r1 = __builtin_amdgcn_permlane32_swap(a1, b1, false, false); \
        u32x4 w = {r0[0], r1[0], r0[1], r1[1]}; OUT = *reinterpret_cast<bf16x8*>(&w); } while (0)
    PK4(p0, 0, pa0); PK4(p0, 8, pa1); PK4(p1, 0, pa2); PK4(p1, 8, pa3);
#undef PK4
}
template <int KB, int NQ>
__device__ __forceinline__ void qkt(f32x16& p0, f32x16& p1, const char* K_lds, int r32, int hi, const bf16x8* qr) {
    p0 = f32x16{}; p1 = f32x16{};
    const char* kb[4];
#pragma unroll
    for (int dd = 0; dd < 4; ++dd) kb[dd] = K_lds + KB * SHM_K + KSWZ(r32, (dd * 16 + hi * 8) * 2);
#pragma unroll
    for (int d0 = 0; d0 < NQ; ++d0) { const char* a = kb[d0 & 3] + (d0 >> 2) * 128;
        bf16x8 b0 = *reinterpret_cast<const bf16x8*>(a);
        bf16x8 b1 = *reinterpret_cast<const bf16x8*>(a + 32 * 256);
        p0 = __builtin_amdgcn_mfma_f32_32x32x16_bf16(b0, qr[d0], p0, 0, 0, 0);
        p1 = __builtin_amdgcn_mfma_f32_32x32x16_bf16(b1, qr[d0], p1, 0, 0, 0); }
}
template <int VB>
__device__ __forceinline__ void pv_tile(f32x16* o, int vb0, bf16x8 pa0, bf16x8 pa1, bf16x8 pa2, bf16x8 pa3) {
#define TRRD(dst, off) asm volatile("ds_read_b64_tr_b16 %0, %1 offset:%2" : "=&v"(dst) : "v"(vb0), "i"(off) : "memory")
#define PV_D0(d0) do { s16x4 l0, l1, l2, l3, h0, h1, h2, h3; constexpr int b_ = VB * SHM_V + v_rd_off(d0, 0, 0); \
        TRRD(l0, b_); TRRD(h0, b_ + 2048); TRRD(l1, b_ + 4096); TRRD(h1, b_ + 6144); TRRD(l2, b_ + 8192); TRRD(h2, b_ + 10240); TRRD(l3, b_ + 12288); TRRD(h3, b_ + 14336); \
        asm volatile("s_waitcnt lgkmcnt(0)" ::: "memory"); SBAR(); \
        o[d0] = __builtin_amdgcn_mfma_f32_32x32x16_bf16(pa0, (bf16x8){l0[0], l0[1], l0[2], l0[3], h0[0], h0[1], h0[2], h0[3]}, o[d0], 0, 0, 0);   \
        o[d0] = __builtin_amdgcn_mfma_f32_32x32x16_bf16(pa1, (bf16x8){l1[0], l1[1], l1[2], l1[3], h1[0], h1[1], h1[2], h1[3]}, o[d0], 0, 0, 0);   \
        o[d0] = __builtin_amdgcn_mfma_f32_32x32x16_bf16(pa2, (bf16x8){l2[0], l2[1], l2[2], l2[3], h2[0], h2[1], h2[2], h2[3]}, o[d0], 0, 0, 0);   \
        o[d0] = __builtin_amdgcn_mfma_f32_32x32x16_bf16(pa3, (bf16x8){l3[0], l3[1], l3[2], l3[3], h3[0], h3[1], h3[2], h3[3]}, o[d0], 0, 0, 0); } while (0)
    PV_D0(0); PV_D0(1); PV_D0(2); PV_D0(3);
#undef PV_D0
#undef TRRD
}

template <bool FOX> struct Item {
    int qb, h, c;
    __device__ __forceinline__ Item(int i) { if (FOX) { qb = 31 - (i >> 3); h = i & 7; c = 0; } else { qb = 31 - (i >> 4); h = (i & 15) >> 1; c = i & 1; } }
    static constexpr size_t RS = (size_t)NH * T * HD, HS = (size_t)T * HD;
    __device__ __forceinline__ const bf16_t* Q(const unsigned char* ws) const { return (const bf16_t*)(ws + WS_QKV) + (FOX ? 3 : 0) * RS + h * HS + (size_t)qb * 256 * HD + c * 64; }
    __device__ __forceinline__ const bf16_t* K(const unsigned char* ws) const { return (const bf16_t*)(ws + WS_QKV) + (FOX ? 4 : 1) * RS + h * HS; }
    __device__ __forceinline__ const bf16_t* V(const unsigned char* ws) const { return (const bf16_t*)(ws + WS_QKV) + (FOX ? 5 : 2) * RS + h * HS; }
    __device__ __forceinline__ const float* NB(const unsigned char* ws) const { return (const float*)(ws + WS_NB) + (size_t)h * T; }
    __device__ __forceinline__ bf16_t* O(unsigned char* ws) const { return FOX ? (bf16_t*)(ws + WS_CAT) + (size_t)qb * 256 * DM + 1024 + h * HD : (bf16_t*)(ws + WS_OD) + (size_t)c * RS + h * HS + (size_t)qb * 256 * HD; }
    static constexpr int LDO = FOX ? DM : HD;
    __device__ __forceinline__ int koff() const { return c * 128; }
    __device__ __forceinline__ int P0() const { return qb * 256; }
};
template <int NQ> struct Seam { bf16x8 qr[NQ]; bf16x8 st_v0, st_v1, st_k0, st_k1; };

#define ROW(p, k0, rr) ((p) + (size_t)((k0) + (rr)) * D + sc)
#define SLOAD_H(Kp, Vp, NBp, k0, bb) do { S.st_v0 = load8(ROW(Vp, k0, sr)); S.st_v1 = load8(ROW(Vp, k0, 32 + sr));              \
                         S.st_k0 = load8(ROW(Kp, k0, sr)); S.st_k1 = load8(ROW(Kp, k0, 32 + sr)); \
                         if constexpr (FOX) { if (wid == 0) __builtin_amdgcn_global_load_lds((const unsigned*)((NBp) + (k0) + lane), (LAS unsigned*)(ldsl + LDS_NB + (bb) * 256), 4, 0, 0); } } while (0)
#define SWRITE_HK(bf) do { *(bf16x8*)(K_lds + (bf) * SHM_K + kws) = S.st_k0; *(bf16x8*)(K_lds + (bf) * SHM_K + kws + 32 * 256) = S.st_k1; } while (0)
#define SWRITE_HV(bf) do { *(bf16x8*)(V_lds + (bf) * SHM_V + vst0) = S.st_v0; *(bf16x8*)(V_lds + (bf) * SHM_V + vst1) = S.st_v1; } while (0)
#define SWRITE_H(bf) do { SWRITE_HV(bf); SWRITE_HK(bf); } while (0)

template <bool FOX>
__device__ __forceinline__ void attn_prime(const Item<FOX> cur, unsigned char* ws, char* lds, LAS unsigned char* ldsl, Seam<FOX ? 8 : 4>& S) {
    constexpr int NQ = FOX ? 8 : 4;
    const int tid = threadIdx.x, wid = __builtin_amdgcn_readfirstlane(tid >> 6), lane = tid & 63, r32 = lane & 31, hi = lane >> 5;
    const int sr = tid >> 4, sc = (tid & 15) * 8, kws = KSWZ(sr, sc * 2); char* K_lds = lds + 2 * SHM_V;
    const int NT = cur.P0() / KVBLK + 4;
    const int kb0 = FOX ? (NT - 1) * KVBLK : 0;
    const bf16_t* Qp = cur.Q(ws);
#pragma unroll
    for (int d0 = 0; d0 < NQ; ++d0) S.qr[d0] = load8(Qp + (size_t)(wid * QBLK + r32) * D + d0 * 16 + hi * 8);
    SLOAD_H(cur.K(ws), cur.V(ws), cur.NB(ws), kb0, 0); VM_WAIT(); SWRITE_HK(0);
    __syncthreads();
}
template <bool FOX>
__device__ __forceinline__ void attn_block(const Item<FOX> cur, const Item<FOX> nxt, unsigned char* ws, char* lds, LAS unsigned char* ldsl, Seam<FOX ? 8 : 4>& S) {
    constexpr int NQ = FOX ? 8 : 4;
    constexpr float scale = FOX ? 0.08838834764831845f : 0.125f;
    const int tid = threadIdx.x, wid = __builtin_amdgcn_readfirstlane(tid >> 6), lane = tid & 63, r32 = lane & 31, hi = lane >> 5;
    const int NT = cur.P0() / KVBLK + 4;
    const int qlo = cur.P0() + wid * QBLK, qm = qlo + r32 - 4 * hi;
    char* V_lds = lds; char* K_lds = lds + 2 * SHM_V; const float* nbuf = (const float*)(lds + LDS_NB);
    const char* K_rd = K_lds + cur.koff();
    float* wsf = (float*)(lds + LDS_WS) + wid * 64; float* li_l = wsf, * al_l = wsf + 32;
    float m_reg = -1e30f, l_reg = 0; f32x16 o[4] = {};
    const int sr = tid >> 4, sc = (tid & 15) * 8, vst0 = v_st(sr, sc), vst1 = v_st(32 + sr, sc), kws = KSWZ(sr, sc * 2);
    const int vb0 = (int)(uintptr_t)V_lds + v_rd_base(lane);
    const bf16_t* Kh = cur.K(ws); const bf16_t* Vh = cur.V(ws); const float* NBh = cur.NB(ws);
#define RESC(a) do { if (__any((a) < 1.f)) { if (hi == 0) al_l[r32] = (a); asm volatile("s_waitcnt lgkmcnt(0)" ::: "memory");              \
                     _Pragma("unroll") for (int d_ = 0; d_ < 4; ++d_) _Pragma("unroll") for (int r = 0; r < 16; ++r) o[d_][r] *= al_l[crow(r, hi)]; } } while (0)
#define KBASE(t) ((FOX ? (NT - 1 - (t)) : (t)) * KVBLK)
#define MASKT(P0_, P1_, t) do { const int kb_ = KBASE(t); if (kb_ + KVBLK - 1 > qlo) mask_tile(P0_, P1_, qm - kb_); } while (0)
#define BIAS(P0_, P1_, BF) do { if constexpr (FOX) { constexpr float C2_ = LOG2E * scale; const float* nb_ = nbuf + (BF) * 64 + 4 * hi; \
        _Pragma("unroll") for (int g_ = 0; g_ < 4; ++g_) { const f32x4 b0_ = *(const f32x4*)(nb_ + 8 * g_), b1_ = *(const f32x4*)(nb_ + 32 + 8 * g_); \
            _Pragma("unroll") for (int i_ = 0; i_ < 4; ++i_) { P0_[4 * g_ + i_] = fmaf(P0_[4 * g_ + i_], C2_, b0_[i_]); P1_[4 * g_ + i_] = fmaf(P1_[4 * g_ + i_], C2_, b1_[i_]); } } } } while (0)
    f32x16 pA0, pA1, pB0, pB1; float mnA, mnB, alA, alB; bf16x8 pa0, pa1, pa2, pa3;
    SWRITE_HV(0); SBAR();
    SLOAD_H(Kh, Vh, NBh, KBASE(1), 1);
    SBAR(); qkt<0, NQ>(pA0, pA1, K_rd, r32, hi, S.qr);
    BIAS(pA0, pA1, 0); MASKT(pA0, pA1, 0); partialSM<FOX>(pA0, pA1, m_reg, mnA, alA, scale);
    VM_WAIT(); SWRITE_H(1);
    __syncthreads();
#define HALF_STEP(PX0, PX1, mnX, alX, PY0, PY1, alY, t, KB, VB, SB) do {                                                      \
        SBAR(); qkt<KB, NQ>(PX0, PX1, K_rd, r32, hi, S.qr);                                                                    \
        finishSM(PY0, PY1, alY, l_reg, pa0, pa1, pa2, pa3); SBAR();                                                           \
        if ((t) + 1 < NT) { SLOAD_H(Kh, Vh, NBh, KBASE((t) + 1), SB); SBAR(); }                                               \
        pv_tile<VB>(o, vb0, pa0, pa1, pa2, pa3); BIAS(PX0, PX1, KB); MASKT(PX0, PX1, (t)); partialSM<FOX>(PX0, PX1, m_reg, mnX, alX, scale); \
        __syncthreads();                                                                                                      \
        if ((t) + 1 < NT) { VM_WAIT(); SWRITE_H(SB); }                                                                        \
        RESC(alX); __syncthreads(); } while (0)
    for (int t = 1; t + 1 < NT; t += 2) {
        HALF_STEP(pB0, pB1, mnB, alB, pA0, pA1, alA, t, 1, 0, 0);
        HALF_STEP(pA0, pA1, mnA, alA, pB0, pB1, alB, t + 1, 0, 1, 1);
    }
    SBAR(); qkt<1, NQ>(pB0, pB1, K_rd, r32, hi, S.qr); SBAR();
    { const int NTn = nxt.P0() / KVBLK + 4; const int kbn = FOX ? (NTn - 1) * KVBLK : 0;
      SLOAD_H(nxt.K(ws), nxt.V(ws), nxt.NB(ws), kbn, 0); SBAR();
      const bf16_t* Qn = nxt.Q(ws);
#pragma unroll
      for (int d0 = 0; d0 < NQ; ++d0) S.qr[d0] = load8(Qn + (size_t)(wid * QBLK + r32) * D + d0 * 16 + hi * 8); }
    SBAR();
    finishSM(pA0, pA1, alA, l_reg, pa0, pa1, pa2, pa3); SBAR();
    pv_tile<0>(o, vb0, pa0, pa1, pa2, pa3);
    BIAS(pB0, pB1, 1); MASKT(pB0, pB1, NT - 1); partialSM<FOX>(pB0, pB1, m_reg, mnB, alB, scale); __syncthreads(); RESC(alB);
    finishSM(pB0, pB1, alB, l_reg, pa0, pa1, pa2, pa3); SBAR(); pv_tile<1>(o, vb0, pa0, pa1, pa2, pa3);
    SBAR();
    asm volatile("s_waitcnt vmcnt(%0)" :: "i"(NQ) : "memory");
    SWRITE_HK(0); SBAR();
    if (hi == 0) li_l[r32] = l_reg; asm volatile("s_waitcnt lgkmcnt(0)" ::: "memory");
    { bf16_t* stg = (bf16_t*)(lds + LDS_OST) + wid * 4096;
#pragma unroll
      for (int r = 0; r < 16; ++r) { const int orow = crow(r, hi); const float rl = __builtin_amdgcn_rcpf(li_l[orow]);
#pragma unroll
          for (int d0 = 0; d0 < 4; ++d0) { const float v = o[d0][r] * rl; stg[orow * 128 + d0 * 32 + r32] = (bf16_t)(cvt_pk_bf16(v, v) & 0xffffu); } }
      asm volatile("s_waitcnt lgkmcnt(0)" ::: "memory");
      bf16_t* Ow = cur.O(ws) + (size_t)(wid * QBLK) * Item<FOX>::LDO;
#pragma unroll
      for (int i = 0; i < 8; ++i) { const int row = i * 4 + (lane >> 4), ch = lane & 15; const u32x4 v = *(const u32x4*)(stg + row * 128 + ch * 8); *(u32x4*)(Ow + (size_t)row * Item<FOX>::LDO + ch * 8) = v; } }
    __syncthreads();
#undef RESC
#undef KBASE
#undef MASKT
#undef BIAS
#undef HALF_STEP
}
#undef ROW
#undef SLOAD_H
#undef SWRITE_HK
#undef SWRITE_HV
#undef SWRITE_H
#undef SBAR
}

constexpr int NWAVES = 8;
struct Frame {
    LAS unsigned char* lds; volatile LAS unsigned* MISC; gu32* ctl; unsigned char* ws;
    int tid, lane, wave, vcu, G;
    const float* in[25]; float* out;
};

template <class RowFn>
__device__ __forceinline__ void transpose_item(const float* W, int ldw, int k0, int n0, LAS float* scr, int lane, const RowFn& rowp) {
#pragma unroll 8
    for (int i = 0; i < 32; ++i) { const int kk = 2 * i + (lane >> 5); scr[kk * 33 + (lane & 31)] = W[(size_t)(k0 + kk) * ldw + n0 + (lane & 31)]; }
    LDS_WAIT(); asm volatile("" ::: "memory");
    const int c = lane & 7;
#pragma unroll
    for (int j = 0; j < 4; ++j) { const int n = (lane >> 3) + 8 * j; const LAS float* s = scr + (8 * c) * 33 + n;
        u32x4 o; o.x = cvt_pk_bf16(s[0 * 33], s[1 * 33]); o.y = cvt_pk_bf16(s[2 * 33], s[3 * 33]); o.z = cvt_pk_bf16(s[4 * 33], s[5 * 33]); o.w = cvt_pk_bf16(s[6 * 33], s[7 * 33]);
        *(u32x4*)(rowp(n0 + n) + k0 + 8 * c) = o; }
    LDS_WAIT(); asm volatile("" ::: "memory");
}

__device__ __forceinline__ void p0_prologue(Frame& F) {
    LAS float* scr = (LAS float*)(F.lds + F.wave * 16384);
    const int gw = F.vcu * NWAVES + F.wave, NGW = F.G * NWAVES, lane = F.lane;
    unsigned char* ws = F.ws;
    {
        const float* x = F.in[0]; const float* gain = F.in[2]; const float* w_in = F.in[3]; const float* bfg = F.in[4];
        bf16_t* XN = (bf16_t*)(ws + WS_XN); float* LOGF = (float*)(ws + WS_LOGF);
        for (int m = gw; m < T; m += NGW) {
            const f32x4* xr = (const f32x4*)(x + (size_t)m * DM) + lane;
            f32x4 v[8]; float s = 0.f;
#pragma unroll
            for (int j = 0; j < 8; ++j) { v[j] = xr[64 * j]; s += (v[j].x * v[j].x + v[j].y * v[j].y) + (v[j].z * v[j].z + v[j].w * v[j].w); }
            const float rstd = 1.f / sqrtf(wave_sum(s) * (1.f / DM) + NORM_EPS);
            float fg[8] = {0.f, 0.f, 0.f, 0.f, 0.f, 0.f, 0.f, 0.f};
            u32x2* o8 = (u32x2*)(XN + (size_t)m * DM) + lane;
#pragma unroll
            for (int j = 0; j < 8; ++j) { const f32x4 g = *((const f32x4*)gain + lane + 64 * j); const f32x4 y = v[j] * rstd * g;
                u32x2 w; w.x = cvt_pk_bf16(y.x, y.y); w.y = cvt_pk_bf16(y.z, y.w); o8[64 * j] = w;
#pragma unroll
                for (int i = 0; i < 4; ++i) { const float* wr = w_in + (size_t)(4 * lane + 256 * j + i) * LDW_IN + NPROJ; const f32x4 wa = *(const f32x4*)wr, wb = *(const f32x4*)(wr + 4);
                    fg[0] += y[i] * wa.x; fg[1] += y[i] * wa.y; fg[2] += y[i] * wa.z; fg[3] += y[i] * wa.w; fg[4] += y[i] * wb.x; fg[5] += y[i] * wb.y; fg[6] += y[i] * wb.z; fg[7] += y[i] * wb.w; } }
#pragma unroll
            for (int h = 0; h < 8; ++h) fg[h] = wave_sum(fg[h]);
            if (lane < 8) { float z = fg[0];
#pragma unroll
                for (int h = 1; h < 8; ++h) z = (lane == h) ? fg[h] : z;
                z += bfg[lane];
                const float lf = fminf(z, 0.f) - log1pf(expf(-fabsf(z)));
                LOGF[lane * T + m] = lf; }
        }
    }
    { const float* p = F.in[1]; bf16_t* PB = (bf16_t*)(ws + WS_PB);
      for (int i = (gw * 64 + lane); i < T * PLE / 8; i += NGW * 64) { const f32x4 a = *((const f32x4*)p + 2 * i), b = *((const f32x4*)p + 2 * i + 1); *((u32x4*)PB + i) = pg8::pack8(a, b); } }
    { float* COS = (float*)(ws + WS_COS); float* SIN = (float*)(ws + WS_SIN);
      for (int i = gw * 64 + lane; i < T * 32; i += NGW * 64) { const int t = i >> 5, j = i & 31; const float inv = powf(10000.f, -(float)(2 * j) / 64.f); const float ang = (float)t * inv; COS[i] = cosf(ang); SIN[i] = sinf(ang); } }
    { int* RL = (int*)(ws + WS_ROWL) + 64 * 8192;
      for (int i = gw * 64 + lane; i < T; i += NGW * 64) RL[i] = 65536 + i; }
    {
        bf16_t* WIN = (bf16_t*)(ws + WS_WIN); bf16_t* WO = (bf16_t*)(ws + WS_WO); bf16_t* WPG = (bf16_t*)(ws + WS_WPG); bf16_t* WPP = (bf16_t*)(ws + WS_WPP); bf16_t* WR = (bf16_t*)(ws + WS_WR);
        bf16_t* WG1 = (bf16_t*)(ws + WS_WG1); bf16_t* WD = (bf16_t*)(ws + WS_WD);
        constexpr int I_IN = 32 * 192, I_O = 32 * 64, I_PG = 32 * 64, I_PP = 4 * 64, I_R = 32 * 2, I_GU = 32 * 16, I_D = 8 * 64;
        constexpr int B_O = I_IN, B_PG = B_O + I_O, B_PP = B_PG + I_PG, B_R = B_PP + I_PP, B_G = B_R + I_R, B_U = B_G + NEX * I_GU, B_D = B_U + NEX * I_GU, NITEMS = B_D + NEX * I_D;
        for (int it = gw; it < NITEMS; it += NGW) {
            if (it < B_O) { const int r = it, kb = r / 192, nb = r % 192;
                transpose_item(F.in[3], LDW_IN, 64 * kb, 32 * nb, scr, lane, [&](int n) { int row = n; if (n < 2048) { const int d = n & 63, g = (n >> 6) & 3; row = (n & ~255) + ((d >> 5) << 7) + (g << 5) + (d & 31); } return WIN + (size_t)row * DM; });
            } else if (it < B_PG) { const int r = it - B_O, kb = r / 64, nb = r % 64;
                transpose_item(F.in[10], DM, 64 * kb, 32 * nb, scr, lane, [&](int n) { return WO + (size_t)n * DM; });
            } else if (it < B_PP) { const int r = it - B_PG, kb = r / 64, nb = r % 64;
                transpose_item(F.in[20], DM, 64 * kb, 32 * nb, scr, lane, [&](int n) { return WPG + (size_t)n * DM; });
            } else if (it < B_R) { const int r = it - B_PP, kb = r / 64, nb = r % 64;
                transpose_item(F.in[22], DM, 64 * kb, 32 * nb, scr, lane, [&](int n) { return WPP + (size_t)n * PLE; });
            } else if (it < B_G) { const int r = it - B_R, kb = r / 2, nb = r % 2;
                transpose_item(F.in[12], NE, 64 * kb, 32 * nb, scr, lane, [&](int n) { return WR + (size_t)n * DM; });
            } else if (it < B_U) { const int r = it - B_G, e = r / I_GU, q = r % I_GU, kb = q / 16, nb = q % 16;
                const float* src = (e < NE) ? F.in[14] + (size_t)e * DM * FE : F.in[17]; bf16_t* dst = WG1 + (size_t)e * 1024 * DM;
                transpose_item(src, FE, 64 * kb, 32 * nb, scr, lane, [&](int n) { return dst + (size_t)((n >> 7) * 256 + (n & 127)) * DM; });
            } else if (it < B_D) { const int r = it - B_U, e = r / I_GU, q = r % I_GU, kb = q / 16, nb = q % 16;
                const float* src = (e < NE) ? F.in[15] + (size_t)e * DM * FE : F.in[18]; bf16_t* dst = WG1 + (size_t)e * 1024 * DM;
                transpose_item(src, FE, 64 * kb, 32 * nb, scr, lane, [&](int n) { return dst + (size_t)((n >> 7) * 256 + 128 + (n & 127)) * DM; });
            } else { const int r = it - B_D, e = r / I_D, q = r % I_D, kb = q / 64, nb = q % 64;
                const float* src = (e < NE) ? F.in[16] + (size_t)e * FE * DM : F.in[19]; bf16_t* dst = WD + (size_t)e * DM * FE;
                transpose_item(src, DM, 64 * kb, 32 * nb, scr, lane, [&](int n) { return dst + (size_t)n * FE; });
            }
        }
    }
}

__device__ __forceinline__ void p1_scan(Frame& F) {
    if (blockIdx.x < NH) {
        const int h = blockIdx.x; const float* lf = (const float*)(F.ws + WS_LOGF) + (size_t)h * T; float* nb = (float*)(F.ws + WS_NB) + (size_t)h * T;
        LAS float* part = (LAS float*)F.lds;
        float v[16]; float s = 0.f;
#pragma unroll
        for (int i = 0; i < 16; ++i) { s += lf[F.tid * 16 + i]; v[i] = s; }
        part[F.tid] = s;
        __syncthreads();
        float pre = 0.f;
        for (int j = 0; j < F.tid; ++j) pre += part[j];
#pragma unroll
        for (int i = 0; i < 16; ++i) nb[F.tid * 16 + i] = -(pre + v[i]) * LOG2E;
        __syncthreads();
    }
}

__device__ __forceinline__ void p3_rows(Frame& F) {
    const int gw = F.vcu * NWAVES + F.wave, NGW = F.G * NWAVES, lane = F.lane;
    float lam;
    { const float a = F.in[5][lane] * F.in[6][lane], b = F.in[7][lane] * F.in[8][lane]; lam = expf(wave_sum(a)) - expf(wave_sum(b)) + 0.2f; }
    const bf16_t* OD = (const bf16_t*)(F.ws + WS_OD); bf16_t* CAT = (bf16_t*)(F.ws + WS_CAT); bf16_t* PE = (bf16_t*)(F.ws + WS_PE);
    const float* subln = F.in[9]; const float* pgain = F.in[23];
    const int h = lane >> 3, sub = lane & 7;
    float sg[16];
#pragma unroll
    for (int i = 0; i < 16; ++i) sg[i] = subln[16 * sub + i] * 0.8f;
    for (int t = gw; t < T; t += NGW) {
        const size_t o1 = ((size_t)h * T + t) * HD + 16 * sub, o2 = o1 + (size_t)NH * T * HD;
        const u32x4 a0 = *(const u32x4*)(OD + o1), a1 = *(const u32x4*)(OD + o1 + 8), b0 = *(const u32x4*)(OD + o2), b1 = *(const u32x4*)(OD + o2 + 8);
        float v[16]; const unsigned aw[8] = {a0.x, a0.y, a0.z, a0.w, a1.x, a1.y, a1.z, a1.w}, bw[8] = {b0.x, b0.y, b0.z, b0.w, b1.x, b1.y, b1.z, b1.w};
        float s = 0.f;
#pragma unroll
        for (int i = 0; i < 8; ++i) { v[2 * i] = bflo(aw[i]) - lam * bflo(bw[i]); v[2 * i + 1] = bfhi(aw[i]) - lam * bfhi(bw[i]); s += v[2 * i] * v[2 * i] + v[2 * i + 1] * v[2 * i + 1]; }
        s += __shfl_xor(s, 1); s += __shfl_xor(s, 2); s += __shfl_xor(s, 4);
        const float rstd = 1.f / sqrtf(s * (1.f / HD) + NORM_EPS);
        u32x4 w0, w1;
        w0.x = cvt_pk_bf16(v[0] * rstd * sg[0], v[1] * rstd * sg[1]); w0.y = cvt_pk_bf16(v[2] * rstd * sg[2], v[3] * rstd * sg[3]); w0.z = cvt_pk_bf16(v[4] * rstd * sg[4], v[5] * rstd * sg[5]); w0.w = cvt_pk_bf16(v[6] * rstd * sg[6], v[7] * rstd * sg[7]);
        w1.x = cvt_pk_bf16(v[8] * rstd * sg[8], v[9] * rstd * sg[9]); w1.y = cvt_pk_bf16(v[10] * rstd * sg[10], v[11] * rstd * sg[11]); w1.z = cvt_pk_bf16(v[12] * rstd * sg[12], v[13] * rstd * sg[13]); w1.w = cvt_pk_bf16(v[14] * rstd * sg[14], v[15] * rstd * sg[15]);
        bf16_t* dst = CAT + (size_t)t * DM + h * HD + 16 * sub;
        *(u32x4*)dst = w0; *(u32x4*)(dst + 8) = w1;
        u32x4* pr = (u32x4*)(PE + (size_t)t * DM) + lane; u32x4 pw[4]; float q = 0.f;
#pragma unroll
        for (int j = 0; j < 4; ++j) { pw[j] = pr[64 * j]; const unsigned ww[4] = {pw[j].x, pw[j].y, pw[j].z, pw[j].w};
#pragma unroll
            for (int i = 0; i < 4; ++i) { const float lo = bflo(ww[i]), hi = bfhi(ww[i]); q += lo * lo + hi * hi; } }
        const float prs = 1.f / sqrtf(wave_sum(q) * (1.f / DM) + NORM_EPS);
#pragma unroll
        for (int j = 0; j < 4; ++j) { const unsigned ww[4] = {pw[j].x, pw[j].y, pw[j].z, pw[j].w}; const f32x4 g0 = *(const f32x4*)(pgain + 8 * lane + 512 * j), g1 = *(const f32x4*)(pgain + 8 * lane + 512 * j + 4);
            u32x4 ow; ow.x = cvt_pk_bf16(bflo(ww[0]) * prs * g0.x, bfhi(ww[0]) * prs * g0.y); ow.y = cvt_pk_bf16(bflo(ww[1]) * prs * g0.z, bfhi(ww[1]) * prs * g0.w);
            ow.z = cvt_pk_bf16(bflo(ww[2]) * prs * g1.x, bfhi(ww[2]) * prs * g1.y); ow.w = cvt_pk_bf16(bflo(ww[3]) * prs * g1.z, bfhi(ww[3]) * prs * g1.w); pr[64 * j] = ow; }
    }
}

constexpr int P5_RS = 4112;
__device__ __forceinline__ void p5_router(Frame& F) {
    const int lane = F.lane, wave = F.wave, tid = F.tid, r32 = lane & 31, hi = lane >> 5;
    const float* H1 = (const float*)(F.ws + WS_H1); bf16_t* XN = (bf16_t*)(F.ws + WS_XN); const bf16_t* WR = (const bf16_t*)(F.ws + WS_WR);
    const float* gain = F.in[11]; const float* rbias = F.in[13];
    float* GW = (float*)(F.ws + WS_GW); int* RL = (int*)(F.ws + WS_ROWL);
    LAS unsigned char* img = F.lds;
    LAS float* part = (LAS float*)F.lds;
    LAS int* hist = (LAS int*)(F.lds + MOE_OFF); LAS int* hbase = hist + 64;
    for (int grp = F.vcu; grp < T / 32; grp += F.G) {
        const int t0 = grp * 32;
        if (tid < 64) hist[tid] = 0;
#pragma unroll 1
        for (int q = 0; q < 4; ++q) { const int row = wave * 4 + q, t = t0 + row;
            const f32x4* xr = (const f32x4*)(H1 + (size_t)t * DM) + lane; f32x4 v[8]; float s = 0.f;
#pragma unroll
            for (int j = 0; j < 8; ++j) { v[j] = xr[64 * j]; s += (v[j].x * v[j].x + v[j].y * v[j].y) + (v[j].z * v[j].z + v[j].w * v[j].w); }
            const float rstd = 1.f / sqrtf(wave_sum(s) * (1.f / DM) + NORM_EPS);
            u32x2* o8 = (u32x2*)(XN + (size_t)t * DM) + lane;
#pragma unroll
            for (int j = 0; j < 8; ++j) { const f32x4 g = *((const f32x4*)gain + lane + 64 * j); const f32x4 y = v[j] * rstd * g; u32x2 w; w.x = cvt_pk_bf16(y.x, y.y); w.y = cvt_pk_bf16(y.z, y.w);
                o8[64 * j] = w; *(LAS u32x2*)(img + row * P5_RS + (4 * lane + 256 * j) * 2) = w; } }
        __syncthreads();
        f32x16 acc0 = {}, acc1 = {};
#pragma unroll 4
        for (int kk = 0; kk < 16; ++kk) { const int k = 256 * wave + 16 * kk + 8 * hi;
            const bf16x8 a = *(const LAS bf16x8*)(img + r32 * P5_RS + k * 2);
            const bf16x8 b0 = *(const bf16x8*)(WR + (size_t)r32 * DM + k), b1 = *(const bf16x8*)(WR + (size_t)(32 + r32) * DM + k);
            acc0 = __builtin_amdgcn_mfma_f32_32x32x16_bf16(a, b0, acc0, 0, 0, 0); acc1 = __builtin_amdgcn_mfma_f32_32x32x16_bf16(a, b1, acc1, 0, 0, 0); }
        __syncthreads();
#pragma unroll
        for (int r = 0; r < 16; ++r) { const int tok = att::crow(r, hi); part[(wave * 32 + tok) * 64 + r32] = acc0[r]; part[(wave * 32 + tok) * 64 + 32 + r32] = acc1[r]; }
        __syncthreads();
        int my_e[4]; int my_lr[4];
#pragma unroll
        for (int q = 0; q < 4; ++q) { const int row = wave * 4 + q; float lg = 0.f;
#pragma unroll
            for (int w = 0; w < 8; ++w) lg += part[(w * 32 + row) * 64 + lane];
            const float sc = __builtin_amdgcn_rcpf(1.f + expf(-lg)); float v = sc + rbias[lane];
            int pe = 0; float ps = 0.f;
#pragma unroll
            for (int k = 0; k < 8; ++k) { const float mx = wave_max(v); const unsigned long long bal = __ballot(v == mx); const int win = __ffsll((long long)bal) - 1;
                const float sw = __shfl(sc, win); if (lane == k) { pe = win; ps = sw; } if (lane == win) v = -__builtin_inff(); }
            float tot = (lane < 8) ? ps : 0.f; tot = wave_sum(tot);
            my_e[q] = pe; my_lr[q] = 0;
            if (lane < 8) { GW[(size_t)(t0 + row) * 8 + lane] = ps / tot * 2.5f; my_lr[q] = __hip_atomic_fetch_add(&hist[pe], 1, __ATOMIC_RELAXED, __HIP_MEMORY_SCOPE_WORKGROUP); } }
        __syncthreads();
        if (tid < 64) { const int c = hist[tid]; hbase[tid] = c ? (int)__hip_atomic_fetch_add(F.ctl + CW_CNT + 32 * tid, (unsigned)c, RLX_AGENT) : 0; }
        __syncthreads();
        if (lane < 8) {
#pragma unroll
            for (int q = 0; q < 4; ++q) { const int row = wave * 4 + q; RL[my_e[q] * 8192 + hbase[my_e[q]] + my_lr[q]] = (t0 + row) * 8 + lane; } }
        __syncthreads();
    }
}

__device__ __forceinline__ int moe_setup(Frame& F) {
    LAS int* cnts = (LAS int*)(F.lds + MOE_OFF + 512); LAS int* tstart = cnts + 66;
    if (F.tid < NEX) cnts[F.tid] = (F.tid < NE) ? (int)__hip_atomic_load(F.ctl + CW_CNT + 32 * F.tid, RLX_AGENT) : T;
    __syncthreads();
    if (F.tid == 0) { int s = 0; for (int e = 0; e < NEX; ++e) { tstart[e] = s; s += (cnts[e] + 255) >> 8; } tstart[NEX] = s; }
    __syncthreads();
    return tstart[NEX];
}

__device__ __forceinline__ void p8_combine(Frame& F) {
    const int gw = F.vcu * NWAVES + F.wave, NGW = F.G * NWAVES, lane = F.lane;
    float* H1 = (float*)(F.ws + WS_H1); bf16_t* HB = (bf16_t*)(F.ws + WS_XN); const bf16_t* OUT = (const bf16_t*)(F.ws + WS_BIG); const float* GW = (const float*)(F.ws + WS_GW);
    for (int t = gw; t < T; t += NGW) {
        float g[9];
#pragma unroll
        for (int k = 0; k < 8; ++k) g[k] = GW[(size_t)t * 8 + k];
        g[8] = 1.f;
#pragma unroll
        for (int j = 0; j < 4; ++j) { const int col = 8 * lane + 512 * j;
            f32x4 a = *(const f32x4*)(H1 + (size_t)t * DM + col), b = *(const f32x4*)(H1 + (size_t)t * DM + col + 4);
#pragma unroll
            for (int k = 0; k < 9; ++k) { const size_t srow = (k < 8) ? (size_t)t * 8 + k : (size_t)65536 + t; const u32x4 w = *(const u32x4*)(OUT + srow * DM + col);
                a.x += g[k] * bflo(w.x); a.y += g[k] * bfhi(w.x); a.z += g[k] * bflo(w.y); a.w += g[k] * bfhi(w.y); b.x += g[k] * bflo(w.z); b.y += g[k] * bfhi(w.z); b.z += g[k] * bflo(w.w); b.w += g[k] * bfhi(w.w); }
            *(f32x4*)(H1 + (size_t)t * DM + col) = a; *(f32x4*)(H1 + (size_t)t * DM + col + 4) = b; *(u32x4*)(HB + (size_t)t * DM + col) = pg8::pack8(a, b); }
    }
}
__device__ __forceinline__ void p10_final(Frame& F) {
    const int gw = F.vcu * NWAVES + F.wave, NGW = F.G * NWAVES, lane = F.lane; const float* gain = F.in[24];
    for (int t = gw; t < T; t += NGW) {
        f32x4* xr = (f32x4*)(F.out + (size_t)t * DM) + lane; f32x4 v[8]; float s = 0.f;
#pragma unroll
        for (int j = 0; j < 8; ++j) { v[j] = xr[64 * j]; s += (v[j].x * v[j].x + v[j].y * v[j].y) + (v[j].z * v[j].z + v[j].w * v[j].w); }
        const float rstd = 1.f / sqrtf(wave_sum(s) * (1.f / DM) + NORM_EPS);
#pragma unroll
        for (int j = 0; j < 8; ++j) { const f32x4 g = *((const f32x4*)gain + lane + 64 * j); xr[64 * j] = v[j] * rstd * g; }
    }
}

struct Args { const float* in[25]; float* out; unsigned char* ws; int ph_lo, ph_hi, li, pad; };
__global__ void __launch_bounds__(NWAVES * 64, 2) fwd_kernel(Args args) {
    extern __shared__ __attribute__((aligned(16))) unsigned char lds[];
    Frame F;
    F.lds = (LAS unsigned char*)lds; F.MISC = (volatile LAS unsigned*)(F.lds + MISC_OFF);
    F.tid = threadIdx.x; F.lane = F.tid & 63; F.wave = __builtin_amdgcn_readfirstlane(F.tid >> 6);
    F.G = gridDim.x; { const int bx = blockIdx.x; F.vcu = (F.G % 8 == 0) ? (bx % 8) * (F.G / 8) + bx / 8 : bx; }
    F.ws = args.ws; F.ctl = (gu32*)(args.ws + WS_CTL); F.out = args.out;
#pragma unroll
    for (int i = 0; i < 25; ++i) F.in[i] = args.in[i];
    if (F.tid < 64) F.MISC[F.tid] = 0u;
    __syncthreads();
    XcdBarrier bar; bar.bar = (unsigned*)(F.ctl + CW_BAR) + args.li * XCD_BAR_WORDS; bar.x = 0; bar.st = nullptr;
    if (MK_N_LAUNCHES != NPH) bar = xcd_barrier_post((unsigned*)(F.ctl + CW_BAR) + args.li * XCD_BAR_WORDS, F.MISC + 0);
    const int lo = args.ph_lo, hi = args.ph_hi;
#ifndef PHMASK
#define PHMASK 0x7ff
#endif
#define IN(k) (((PHMASK >> (k)) & 1) && lo <= (k) && (k) < hi)
#define SEAM(k) do { if (IN(k) && IN((k) + 1)) xcd_barrier(bar); } while (0)
    unsigned char* ws = args.ws;

    if (IN(0)) { p0_prologue(F); SEAM(0); }

    if (IN(1)) {
        p1_scan(F);
        { pg8::SchedDense S; S.init((const bf16_t*)(ws + WS_XN), (const bf16_t*)(ws + WS_WIN), T, NPROJ, DM, F.G, (int)blockIdx.x);
          pg8::EpiInProj E{(bf16_t*)(ws + WS_QKV), (const float*)(ws + WS_COS), (const float*)(ws + WS_SIN)};
          pg8::gemm_phase<pg8::EpiInProj, pg8::SchedDense, true, false>(F.lds, DM, S, E); }
        { pg8::SchedDense S; S.init((const bf16_t*)(ws + WS_PB), (const bf16_t*)(ws + WS_WPP), T, DM, PLE, F.G, (int)blockIdx.x);
          pg8::EpiBf16 E{(bf16_t*)(ws + WS_PE), DM};
          int Kp = PLE; asm volatile("" : "+s"(Kp));
          pg8::gemm_phase<pg8::EpiBf16, pg8::SchedDense, true, false>(F.lds, Kp, S, E); }
        SEAM(1);
    }

    if (IN(2)) {
#ifndef ATT_MASK
#define ATT_MASK 3
#endif
        if (ATT_MASK & 1) {
            att::Seam<8> S;
            int idx = (int)blockIdx.x;
            if (idx < 256) {
                att::attn_prime<true>(att::Item<true>(idx), ws, (char*)lds, F.lds, S);
                for (;;) {
                    if (F.tid == 0) F.MISC[4] = __hip_atomic_fetch_add(F.ctl + CW_QFOX, 1u, RLX_AGENT) + (unsigned)F.G;
                    __syncthreads();
                    const int nidx = (int)__builtin_amdgcn_readfirstlane(F.MISC[4]); const bool more = nidx < 256;
                    att::attn_block<true>(att::Item<true>(idx), att::Item<true>(more ? nidx : idx), ws, (char*)lds, F.lds, S);
                    if (!more) break;
                    idx = nidx;
                }
            }
        }
        if (ATT_MASK & 2) {
            att::Seam<4> S;
            __syncthreads();
            if (F.tid == 0) F.MISC[4] = __hip_atomic_fetch_add(F.ctl + CW_QDIFF, 1u, RLX_AGENT);
            __syncthreads();
            int idx = (int)__builtin_amdgcn_readfirstlane(F.MISC[4]);
            if (idx < 512) {
                att::attn_prime<false>(att::Item<false>(idx), ws, (char*)lds, F.lds, S);
                for (;;) {
                    if (F.tid == 0) F.MISC[4] = __hip_atomic_fetch_add(F.ctl + CW_QDIFF, 1u, RLX_AGENT);
                    __syncthreads();
                    const int nidx = (int)__builtin_amdgcn_readfirstlane(F.MISC[4]); const bool more = nidx < 512;
                    att::attn_block<false>(att::Item<false>(idx), att::Item<false>(more ? nidx : idx), ws, (char*)lds, F.lds, S);
                    if (!more) break;
                    idx = nidx;
                }
            }
        }
        SEAM(2);
    }

    if (IN(3)) { p3_rows(F); SEAM(3); }

    if (IN(4)) {
        pg8::SchedDense S; S.init((const bf16_t*)(ws + WS_CAT), (const bf16_t*)(ws + WS_WO), T, DM, DM, F.G, (int)blockIdx.x);
        pg8::EpiResF32 E{F.in[0], (float*)(ws + WS_H1), DM};
        pg8::gemm_phase<pg8::EpiResF32, pg8::SchedDense, false, false>(F.lds, DM, S, E);
        SEAM(4);
    }

    if (IN(5)) { p5_router(F); SEAM(5); }

    if (IN(6)) {
        const int MT = moe_setup(F);
        pg8::SchedMoe S; S.A = (const char*)(ws + WS_XN); S.Bt = (const char*)(ws + WS_WG1); S.estride = (size_t)1024 * DM * 2; S.tstep = (size_t)256 * DM * 2; S.rowlist = (const int*)(ws + WS_ROWL);
        S.cnts = (const LAS int*)(F.lds + MOE_OFF + 512); S.tstart = S.cnts + 66; S.nN = 4; S.total = MT * 4; S.G = F.G; S.c = F.vcu; S.K = DM; S.g1 = 1;
        pg8::EpiG1 E{(bf16_t*)(ws + WS_HID)};
        pg8::gemm_phase<pg8::EpiG1, pg8::SchedMoe, true, true>(F.lds, DM, S, E);
        SEAM(6);
    }

    if (IN(7)) {
        const int MT = moe_setup(F);
        pg8::SchedMoe S; S.A = (const char*)(ws + WS_HID); S.Bt = (const char*)(ws + WS_WD); S.estride = (size_t)DM * FE * 2; S.tstep = (size_t)256 * FE * 2; S.rowlist = (const int*)(ws + WS_ROWL);
        S.cnts = (const LAS int*)(F.lds + MOE_OFF + 512); S.tstart = S.cnts + 66; S.nN = 8; S.total = MT * 8; S.G = F.G; S.c = F.vcu; S.K = FE; S.g1 = 0;
        pg8::EpiG2 E{(bf16_t*)(ws + WS_BIG)};
        pg8::gemm_phase<pg8::EpiG2, pg8::SchedMoe, true, true>(F.lds, FE, S, E);
        SEAM(7);
    }

    if (IN(8)) { p8_combine(F); SEAM(8); }

    if (IN(9)) {
        pg8::SchedDense S; S.init((const bf16_t*)(ws + WS_XN), (const bf16_t*)(ws + WS_WPG), T, DM, DM, F.G, (int)blockIdx.x);
        pg8::EpiPle E{(const float*)(ws + WS_H1), (const bf16_t*)(ws + WS_PE), F.in[21], F.out};
        pg8::gemm_phase<pg8::EpiPle, pg8::SchedDense, false, false>(F.lds, DM, S, E);
        SEAM(9);
    }

    if (IN(10)) { p10_final(F); }
#undef IN
#undef SEAM
}

extern "C" void kernel_launch(void* const* d_in, const int* in_sizes, int n_in, void* d_out, int out_size, void* d_ws, size_t ws_size, hipStream_t stream) {
    static int grid = 0;
    if (grid == 0) {
        if (n_in != 25 || in_sizes[0] != T * DM || out_size != T * DM || ws_size < WS_END) { fprintf(stderr, "kernel_launch: unexpected shapes (n_in %d, in0 %d, out %d, ws %zu); nothing launched\n", n_in, n_in > 0 ? in_sizes[0] : -1, out_size, ws_size); grid = -1; return; }
        int dev = 0, cus = 0, per_cu = 0;
        if (hipGetDevice(&dev) != hipSuccess || hipDeviceGetAttribute(&cus, hipDeviceAttributeMultiprocessorCount, dev) != hipSuccess) { grid = -1; return; }
        if (hipFuncSetAttribute((const void*)fwd_kernel, hipFuncAttributeMaxDynamicSharedMemorySize, LDS_BYTES) != hipSuccess) { fprintf(stderr, "kernel_launch: hipFuncSetAttribute failed\n"); grid = -1; return; }
        if (hipOccupancyMaxActiveBlocksPerMultiprocessor(&per_cu, (const void*)fwd_kernel, NWAVES * 64, LDS_BYTES) != hipSuccess || per_cu < 1) fprintf(stderr, "kernel_launch: occupancy query reports %d\n", per_cu);
        (void)hipGetLastError();
        grid = cus;
    }
    if (grid < 0) return;
    if (hipMemsetAsync((char*)d_ws + WS_CTL, 0, CTL_ZERO_BYTES, stream) != hipSuccess) return;
    Args a{};
    for (int i = 0; i < 25; ++i) a.in[i] = (const float*)d_in[i];
    a.out = (float*)d_out; a.ws = (unsigned char*)d_ws; a.pad = 0;
    if (MK_N_LAUNCHES == 1) { a.ph_lo = 0; a.ph_hi = NPH; a.li = 0; hipLaunchKernelGGL(fwd_kernel, dim3(grid), dim3(NWAVES * 64), LDS_BYTES, stream, a); }
    else for (int li = 0; li < NPH; ++li) { a.ph_lo = li; a.ph_hi = li + 1; a.li = 0; hipLaunchKernelGGL(fwd_kernel, dim3(grid), dim3(NWAVES * 64), LDS_BYTES, stream, a); }
}
```
